# Optimizing an MI355X kernel written in HIP

```python
import jax, jax.numpy as jnp
from jax import lax
import numpy as np

D_MODEL = 2048
BATCH = 2
SEQ = 4096
DEPTH = 2
DEC_BATCH = 16
DEC_SEQ = 64
PAST_LEN = 4096

CHUNK = 64
N_HEADS = 16
HEAD_DIM = D_MODEL // N_HEADS
Q_BLOCK = 128
MLP_CHUNK = 128
N_GROUPS = 8
GROUP_DIM = D_MODEL // N_GROUPS
D_FF = 11 * D_MODEL // 4
CONV_W = 3
PLE_DIM = 256
N_SB_LAYERS = (DEPTH + 1) // 2
N_MLP_LAYERS = DEPTH // 2
EPS = 1e-6

kernel_name = "stickbreak_chunkmlp_convffn_stream_step"


def rmsnorm(x, g):
    xf = x.astype(jnp.float32)
    y = xf * lax.rsqrt(jnp.mean(xf * xf, axis=-1, keepdims=True) + EPS)
    return y.astype(x.dtype) * g


def stick_breaking(q, k, v, q_pos, k_pos):
    z = jnp.einsum("bqhd,bkhd->bhqk", q, k).astype(jnp.float32) * (HEAD_DIM ** -0.5)
    mask = k_pos[None, :] < q_pos[:, None]
    log_keep = jnp.where(mask, jax.nn.log_sigmoid(-z), 0.0)
    log_after = lax.cumsum(log_keep, axis=3, reverse=True) - log_keep
    w = jnp.where(mask, jnp.exp(jax.nn.log_sigmoid(z) + log_after), 0.0)
    return jnp.einsum("bhqk,bkhd->bqhd", w.astype(v.dtype), v)


def sb_mixer(hn, w_qkv, w_o, cache_k, cache_v):
    B, T, _ = hn.shape
    qkv = (hn @ w_qkv).reshape(B, T, 3, N_HEADS, HEAD_DIM)
    q, k, v = qkv[:, :, 0], qkv[:, :, 1], qkv[:, :, 2]
    if cache_k is None:
        blocks = []
        for lo in range(0, T, Q_BLOCK):
            hi = lo + Q_BLOCK
            blocks.append(stick_breaking(q[:, lo:hi], k[:, :hi], v[:, :hi],
                                         jnp.arange(lo, hi), jnp.arange(hi)))
        o = jnp.concatenate(blocks, axis=1)
    else:
        past = cache_k.shape[1]
        kk = jnp.concatenate([cache_k, k], axis=1)
        vv = jnp.concatenate([cache_v, v], axis=1)
        o = stick_breaking(q, kk, vv, past + jnp.arange(T), jnp.arange(past + T))
    return o.reshape(B, T, D_MODEL) @ w_o, k, v


def chunk_mlp(hn, w_in, g_v, w_s, b_s, w_o):
    B, T, _ = hn.shape
    u, v = jnp.split(jax.nn.gelu(hn @ w_in), 2, axis=-1)
    v = rmsnorm(v, g_v)
    L = min(T, MLP_CHUNK)
    blk = jnp.arange(MLP_CHUNK) // CHUNK
    w_sp = jnp.where(blk[None, :] <= blk[:, None], w_s, 0.0)[:, :L, :L]
    vc = v.reshape(B, T // L, L, N_GROUPS, GROUP_DIM)
    mix = jnp.einsum("gts,bcsgd->bctgd", w_sp, vc) + b_s[:, :L].T[:, :, None]
    y = u * mix.reshape(B, T, D_MODEL)
    return y @ w_o, v


def conv_ffn(hn, conv_state, w_up, conv_w, conv_b, w_down):
    a, g = jnp.split(hn @ w_up, 2, axis=-1)
    B, T, _ = a.shape
    if conv_state is None:
        conv_state = jnp.zeros((B, CONV_W - 1, D_FF), a.dtype)
    ext = jnp.concatenate([conv_state, a], axis=1)
    ac = conv_b + ext[:, 0:T] * conv_w[0]
    for j in range(1, CONV_W):
        ac = ac + ext[:, j:j + T] * conv_w[j]
    y = (jax.nn.gelu(ac) * g) @ w_down
    return y, ext[:, T:]


def trunk(x, p, cache_k, cache_v, state_conv, g_mix, w_qkv, w_o_sb, w_in_mlp, g_v_mlp,
          w_s_mlp, b_s_mlp, w_o_mlp, g_ffn, w_up, conv_w, conv_b, w_down, g_ple, w_ple,
          w_ple_gate, g_final):
    h = x
    ks, vs, mlp_vs, convs = [], [], [], []
    for i in range(DEPTH):
        hn = rmsnorm(h, g_mix[i])
        j = i // 2
        if i % 2 == 0:
            y, k, v = sb_mixer(hn, w_qkv[j], w_o_sb[j],
                               None if cache_k is None else cache_k[j],
                               None if cache_v is None else cache_v[j])
            ks.append(k)
            vs.append(v)
        else:
            y, vrow = chunk_mlp(hn, w_in_mlp[j], g_v_mlp[j], w_s_mlp[j], b_s_mlp[j], w_o_mlp[j])
            mlp_vs.append(vrow)
        h = h + y
        y, cs = conv_ffn(rmsnorm(h, g_ffn[i]), None if state_conv is None else state_conv[i],
                         w_up[i], conv_w[i], conv_b[i], w_down[i])
        convs.append(cs)
        h = h + y
        h = h + jax.nn.sigmoid(rmsnorm(h, g_ple[i]) @ w_ple_gate[i]) * (p[i] @ w_ple[i])
    return rmsnorm(h, g_final), jnp.stack(ks), jnp.stack(vs), mlp_vs, jnp.stack(convs)


def setup_inputs(seed: int = 0) -> dict:
    key = jax.random.key(seed)
    ks = iter(jax.random.split(key, 32))
    f32 = jnp.float32

    def nrm(shape, scale=1.0):
        return jax.random.normal(next(ks), shape, f32) * scale

    def gain(shape):
        return 1.0 + 0.02 * jax.random.normal(next(ks), shape, f32)

    return {
        "x_prompt": nrm((BATCH, SEQ, D_MODEL)),
        "x_sample": nrm((DEC_BATCH, DEC_SEQ, D_MODEL)),
        "p_prompt": nrm((DEPTH, BATCH, SEQ, PLE_DIM)),
        "p_sample": nrm((DEPTH, DEC_BATCH, DEC_SEQ, PLE_DIM)),
        "cache_k": nrm((N_SB_LAYERS, DEC_BATCH, PAST_LEN, N_HEADS, HEAD_DIM)),
        "cache_v": nrm((N_SB_LAYERS, DEC_BATCH, PAST_LEN, N_HEADS, HEAD_DIM)),
        "state_conv": nrm((DEPTH, DEC_BATCH, CONV_W - 1, D_FF)),
        "g_mix": gain((DEPTH, D_MODEL)),
        "w_qkv": nrm((N_SB_LAYERS, D_MODEL, 3 * D_MODEL), D_MODEL ** -0.5),
        "w_o_sb": nrm((N_SB_LAYERS, D_MODEL, D_MODEL), D_MODEL ** -0.5),
        "w_in_mlp": nrm((N_MLP_LAYERS, D_MODEL, 2 * D_MODEL), D_MODEL ** -0.5),
        "g_v_mlp": gain((N_MLP_LAYERS, D_MODEL)),
        "w_s_mlp": nrm((N_MLP_LAYERS, N_GROUPS, MLP_CHUNK, MLP_CHUNK), MLP_CHUNK ** -0.5),
        "b_s_mlp": gain((N_MLP_LAYERS, N_GROUPS, MLP_CHUNK)),
        "w_o_mlp": nrm((N_MLP_LAYERS, D_MODEL, D_MODEL), D_MODEL ** -0.5),
        "g_ffn": gain((DEPTH, D_MODEL)),
        "w_up": nrm((DEPTH, D_MODEL, 2 * D_FF), D_MODEL ** -0.5),
        "conv_w": nrm((DEPTH, CONV_W, D_FF), CONV_W ** -0.5),
        "conv_b": nrm((DEPTH, D_FF), 0.02),
        "w_down": nrm((DEPTH, D_FF, D_MODEL), D_FF ** -0.5),
        "g_ple": gain((DEPTH, D_MODEL)),
        "w_ple": nrm((DEPTH, PLE_DIM, D_MODEL), PLE_DIM ** -0.5),
        "w_ple_gate": nrm((DEPTH, D_MODEL, D_MODEL), D_MODEL ** -0.5),
        "g_final": gain((D_MODEL,)),
    }


def reference(x_prompt, x_sample, p_prompt, p_sample, cache_k, cache_v, state_conv, g_mix,
              w_qkv, w_o_sb, w_in_mlp, g_v_mlp, w_s_mlp, b_s_mlp, w_o_mlp, g_ffn, w_up,
              conv_w, conv_b, w_down, g_ple, w_ple, w_ple_gate, g_final):
    y_prompt, k_prompt, v_prompt, _, conv_prompt = trunk(
        x_prompt, p_prompt, None, None, None, g_mix, w_qkv, w_o_sb, w_in_mlp, g_v_mlp,
        w_s_mlp, b_s_mlp, w_o_mlp, g_ffn, w_up, conv_w, conv_b, w_down, g_ple, w_ple,
        w_ple_gate, g_final)
    y_sample, k_sample, v_sample, mlp_v_sample, conv_sample = trunk(
        x_sample, p_sample, cache_k, cache_v, state_conv, g_mix, w_qkv, w_o_sb, w_in_mlp,
        g_v_mlp, w_s_mlp, b_s_mlp, w_o_mlp, g_ffn, w_up, conv_w, conv_b, w_down, g_ple,
        w_ple, w_ple_gate, g_final)
    mlpv_sample = jnp.stack(mlp_v_sample)
    return (y_prompt, y_sample, k_prompt, v_prompt, k_sample, v_sample, mlpv_sample,
            conv_prompt, conv_sample)
```

```cpp
#include <hip/hip_runtime.h>
#include <cstdio>
#include <cstdint>
namespace pg8 {
#define PG8_LAS __attribute__((address_space(3)))
typedef unsigned short bf16_t;
typedef short bf16x8 __attribute__((ext_vector_type(8)));
typedef float f32x4 __attribute__((ext_vector_type(4)));
typedef unsigned u32x4 __attribute__((ext_vector_type(4)));
constexpr int BM = 256, BK = 64, HALF = 128, HTB = HALF * BK * 2  , STAGE_BYTES = 8 * HTB, NXCD = 8, WGM = 8;

__host__ __device__ __forceinline__ int lds_byte(int r, int c) { const int st = (r >> 4) * 2 + (c >> 5), rr = r & 15, cc = c & 31, ob = rr * 64 + cc * 2; return st * 1024 + (ob ^ (((ob >> 9) & 1) << 5)); }
__host__ __device__ __forceinline__ void stage_rc(int b, int& R, int& C) { const int st = b / 1024, sb = b % 1024, swz = sb ^ (((sb >> 9) & 1) << 5); R = (st >> 1) * 16 + swz / 64; C = (st & 1) * 32 + (swz % 64) / 2; }
__host__ __device__ __forceinline__ int perm32(int rho) { const int n = rho >> 4, i = rho & 15; return 8 * (i >> 2) + 4 * n + (i & 3); }

struct Unit { int pm, pn; };
struct Gemm { const bf16_t* A; const bf16_t* Bt; int M, N, K; };

struct StaticOrder {
    int nM, nN, nwg, G, c;
    __host__ __device__ void init(int M, int N, int G_, int c_) { nM = M / BM; nN = N / BM; nwg = nM * nN; G = G_; c = c_; }
    __host__ __device__ bool next(int i, Unit& u) const {
        const long L = (long)i * G + c; if (L >= nwg) return false;
        int wgid = (int)L; { const int q = nwg / NXCD, r = nwg % NXCD, xcd = wgid % NXCD, off = wgid / NXCD; wgid = (xcd < r ? xcd * (q + 1) : r * (q + 1) + (xcd - r) * q) + off; }
        const int nig = WGM * nN, gid = wgid / nig, fm = gid * WGM, gsz = (nM - fm) < WGM ? (nM - fm) : WGM;
        u.pm = fm + ((wgid % nig) % gsz); u.pn = (wgid % nig) / gsz; return true;
    }
    __device__ __forceinline__ void a_ready(const Unit&) const {}
    __device__ __forceinline__ void done(const Unit&) const {}
};
__device__ __forceinline__ unsigned cvt_pk_bf16(float lo, float hi) { unsigned r; asm volatile("v_cvt_pk_bf16_f32 %0, %1, %2" : "=v"(r) : "v"(lo), "v"(hi)); return r; }
typedef float f32x2 __attribute__((ext_vector_type(2)));
typedef unsigned u32x2 __attribute__((ext_vector_type(2)));
constexpr int LD = 2048;
constexpr int PROMPT_TILES = 32;
constexpr float NORM_EPS = 1e-6f;
__device__ __forceinline__ float rstd_of(float ss) { return __builtin_amdgcn_rsqf(ss * (1.0f / 2048.0f) + NORM_EPS); }
__device__ __forceinline__ float sigmoid_f(float x) { return __builtin_amdgcn_rcpf(1.0f + __builtin_amdgcn_exp2f(-1.4426950408889634f * x)); }
__device__ __forceinline__ float gelu_tanh(float x) { const float u = x * (1.5957691216057308f + 0.0713548162726009f * x * x); return x * sigmoid_f(u); }

struct EpiQKV {
    static constexpr bool PERM = false, AFTER_DRAIN = false;
    bf16_t* Q; float* outb; const float* ss;
    static constexpr size_t OFF_KP = (size_t)9216 * 2048, PSZ = (size_t)8192 * 2048, SSZ = (size_t)1024 * 2048, OFF_KS = OFF_KP + 2 * PSZ;
    __device__ __forceinline__ void operator()(const f32x4 (&acc)[2][2][4][2], const Unit& u, int wr, int wc, int fr, int fq) const {
        const int rt = wr * 64 + fr, which = u.pn >> 3, colt = (u.pn & 7) * BM + wc * 32 + 4 * fq;
        float rs[2][4];
#pragma unroll
        for (int ai = 0; ai < 2; ++ai)
#pragma unroll
            for (int m = 0; m < 4; ++m) rs[ai][m] = rstd_of(ss[u.pm * BM + ai * HALF + m * 16 + rt]);
        if (which == 0) {
            bf16_t* base = Q + (size_t)(u.pm * BM + rt) * LD + colt;
#pragma unroll
            for (int ai = 0; ai < 2; ++ai)
#pragma unroll
                for (int m = 0; m < 4; ++m) { bf16_t* rowp = base + (size_t)(ai * HALF + m * 16) * LD;
#pragma unroll
                    for (int bj = 0; bj < 2; ++bj)
#pragma unroll
                        for (int n = 0; n < 2; ++n) { const f32x4 v = acc[ai][bj][m][n] * rs[ai][m]; u32x2 w; w.x = cvt_pk_bf16(v[0], v[1]); w.y = cvt_pk_bf16(v[2], v[3]); *(u32x2*)(rowp + bj * HALF + n * 16) = w; } }
        } else {
            const size_t off = u.pm < PROMPT_TILES ? OFF_KP + (size_t)(which - 1) * PSZ + (size_t)(u.pm * BM + rt) * LD : OFF_KS + (size_t)(which - 1) * SSZ + (size_t)((u.pm - PROMPT_TILES) * BM + rt) * LD;
            float* base = outb + off + colt;
#pragma unroll
            for (int ai = 0; ai < 2; ++ai)
#pragma unroll
                for (int m = 0; m < 4; ++m) { float* rowp = base + (size_t)(ai * HALF + m * 16) * LD;
#pragma unroll
                    for (int bj = 0; bj < 2; ++bj)
#pragma unroll
                        for (int n = 0; n < 2; ++n) *(f32x4*)(rowp + bj * HALF + n * 16) = acc[ai][bj][m][n] * rs[ai][m]; }
        }
    }
};

struct EpiRes {
    static constexpr bool PERM = false, AFTER_DRAIN = false;
    const float* r0; const float* r1;
    float* H; bf16_t* XB; float* ssout;
    __device__ __forceinline__ void operator()(const f32x4 (&acc)[2][2][4][2], const Unit& u, int wr, int wc, int fr, int fq) const {
        const int rt = wr * 64 + fr, col0 = u.pn * BM + wc * 32 + 4 * fq;
        const float* rbase = (u.pm < PROMPT_TILES ? r0 + (size_t)(u.pm * BM + rt) * LD : r1 + (size_t)((u.pm - PROMPT_TILES) * BM + rt) * LD) + col0;
        const size_t obase = (size_t)(u.pm * BM + rt) * LD + col0;
#pragma unroll
        for (int ai = 0; ai < 2; ++ai)
#pragma unroll
            for (int m = 0; m < 4; ++m) { const size_t ro = (size_t)(ai * HALF + m * 16) * LD; float sq = 0.f;
#pragma unroll
                for (int bj = 0; bj < 2; ++bj)
#pragma unroll
                    for (int n = 0; n < 2; ++n) { const f32x4 rv = *(const f32x4*)(rbase + ro + bj * HALF + n * 16); const f32x4 v = rv + acc[ai][bj][m][n];
                        *(f32x4*)(H + obase + ro + bj * HALF + n * 16) = v; u32x2 w; w.x = cvt_pk_bf16(v[0], v[1]); w.y = cvt_pk_bf16(v[2], v[3]); *(u32x2*)(XB + obase + ro + bj * HALF + n * 16) = w;
                        sq += (v[0] * v[0] + v[1] * v[1]) + (v[2] * v[2] + v[3] * v[3]); }
                sq += __shfl_xor(sq, 16); sq += __shfl_xor(sq, 32);
                if (fq == 0) unsafeAtomicAdd(ssout + u.pm * BM + ai * HALF + m * 16 + rt, sq);
                if (m & 1) asm volatile("" ::: "memory"); }
    }
};

struct EpiGate {
    static constexpr bool PERM = false, AFTER_DRAIN = false;
    float* H; const bf16_t* E; bf16_t* XB; const float* ssin; float* ssout;
    __device__ __forceinline__ void operator()(const f32x4 (&acc)[2][2][4][2], const Unit& u, int wr, int wc, int fr, int fq) const {
        const int rt = wr * 64 + fr, col0 = u.pn * BM + wc * 32 + 4 * fq;
        const size_t obase = (size_t)(u.pm * BM + rt) * LD + col0;
#pragma unroll
        for (int ai = 0; ai < 2; ++ai)
#pragma unroll
            for (int m = 0; m < 4; ++m) { const size_t ro = (size_t)(ai * HALF + m * 16) * LD; float sq = 0.f; const int grow = u.pm * BM + ai * HALF + m * 16 + rt; const float rs = rstd_of(ssin[grow]);
#pragma unroll
                for (int bj = 0; bj < 2; ++bj)
#pragma unroll
                    for (int n = 0; n < 2; ++n) { const size_t o = obase + ro + bj * HALF + n * 16; const f32x4 hv = *(const f32x4*)(H + o); const u32x2 ev = *(const u32x2*)(E + o); const f32x4 a = acc[ai][bj][m][n] * rs;
                        f32x4 v; v[0] = hv[0] + sigmoid_f(a[0]) * __uint_as_float(ev.x << 16); v[1] = hv[1] + sigmoid_f(a[1]) * __uint_as_float(ev.x & 0xffff0000u);
                        v[2] = hv[2] + sigmoid_f(a[2]) * __uint_as_float(ev.y << 16); v[3] = hv[3] + sigmoid_f(a[3]) * __uint_as_float(ev.y & 0xffff0000u);
                        *(f32x4*)(H + o) = v; u32x2 w; w.x = cvt_pk_bf16(v[0], v[1]); w.y = cvt_pk_bf16(v[2], v[3]); *(u32x2*)(XB + o) = w;
                        sq += (v[0] * v[0] + v[1] * v[1]) + (v[2] * v[2] + v[3] * v[3]); }
                sq += __shfl_xor(sq, 16); sq += __shfl_xor(sq, 32);
                if (fq == 0) unsafeAtomicAdd(ssout + grow, sq);
                if (m & 1) asm volatile("" ::: "memory"); }
    }
};

struct EpiScaleBf16 {
    static constexpr bool PERM = true, AFTER_DRAIN = false;
    bf16_t* O; int ldc; const float* ss;
    __device__ __forceinline__ void operator()(const f32x4 (&acc)[2][2][4][2], const Unit& u, int wr, int wc, int fr, int fq) const {
        const int rt = wr * 64 + fr, col0 = u.pn * BM + wc * 32 + 8 * fq;
        bf16_t* base = O + (size_t)(u.pm * BM + rt) * ldc + col0;
#pragma unroll
        for (int ai = 0; ai < 2; ++ai)
#pragma unroll
            for (int m = 0; m < 4; ++m) { bf16_t* rowp = base + (size_t)(ai * HALF + m * 16) * ldc; const float rs = ss ? rstd_of(ss[u.pm * BM + ai * HALF + m * 16 + rt]) : 1.0f;
#pragma unroll
                for (int bj = 0; bj < 2; ++bj) { const f32x4 v0 = acc[ai][bj][m][0] * rs, v1 = acc[ai][bj][m][1] * rs;
                    u32x4 w; w.x = cvt_pk_bf16(v0[0], v0[1]); w.y = cvt_pk_bf16(v0[2], v0[3]); w.z = cvt_pk_bf16(v1[0], v1[1]); w.w = cvt_pk_bf16(v1[2], v1[3]);
                    *(u32x4*)(rowp + bj * HALF) = w; } }
    }
};

struct EpiIn {
    static constexpr bool PERM = true, AFTER_DRAIN = false;
    bf16_t* U; bf16_t* V; const float* ssin; float* ssv;
    __device__ __forceinline__ void operator()(const f32x4 (&acc)[2][2][4][2], const Unit& u, int wr, int wc, int fr, int fq) const {
        const int rt = wr * 64 + fr, isv = u.pn >> 3, col0 = (u.pn & 7) * BM + wc * 32 + 8 * fq;
        bf16_t* base = (isv ? V : U) + (size_t)(u.pm * BM + rt) * LD + col0;
#pragma unroll
        for (int ai = 0; ai < 2; ++ai)
#pragma unroll
            for (int m = 0; m < 4; ++m) { bf16_t* rowp = base + (size_t)(ai * HALF + m * 16) * LD; const int grow = u.pm * BM + ai * HALF + m * 16 + rt; const float rs = rstd_of(ssin[grow]); float sq = 0.f;
#pragma unroll
                for (int bj = 0; bj < 2; ++bj) { f32x4 v0 = acc[ai][bj][m][0] * rs, v1 = acc[ai][bj][m][1] * rs;
#pragma unroll
                    for (int j = 0; j < 4; ++j) { v0[j] = gelu_tanh(v0[j]); v1[j] = gelu_tanh(v1[j]); }
                    sq += (v0[0] * v0[0] + v0[1] * v0[1]) + (v0[2] * v0[2] + v0[3] * v0[3]) + (v1[0] * v1[0] + v1[1] * v1[1]) + (v1[2] * v1[2] + v1[3] * v1[3]);
                    u32x4 w; w.x = cvt_pk_bf16(v0[0], v0[1]); w.y = cvt_pk_bf16(v0[2], v0[3]); w.z = cvt_pk_bf16(v1[0], v1[1]); w.w = cvt_pk_bf16(v1[2], v1[3]);
                    *(u32x4*)(rowp + bj * HALF) = w; }
                if (isv) { sq += __shfl_xor(sq, 16); sq += __shfl_xor(sq, 32); if (fq == 0) unsafeAtomicAdd(ssv + grow, sq); } }
    }
};

template <class Epi, class Sched, bool ALIGN_EPI = false, bool SP2 = false>
__device__ __forceinline__ void gemm_phase(PG8_LAS unsigned char* lds, const Gemm g, const Sched& S, const Epi& E) {
    const int tid = threadIdx.x, wid = __builtin_amdgcn_readfirstlane(tid >> 6), lane = tid & 63, wr = wid >> 2, wc = wid & 3, fr = lane & 15, fq = lane >> 4;
    const int K = g.K, nt = K / BK;
    unsigned voffA[2], voffB[2];
#pragma unroll
    for (int i = 0; i < 2; ++i) { int R, C; stage_rc(tid * 16 + i * 8192, R, C); const int Rb = Epi::PERM ? ((R & ~31) + perm32(R & 31)) : R;
        voffA[i] = (unsigned)(R * K + C) * 2u; voffB[i] = (unsigned)(Rb * K + C) * 2u; }
    const size_t kstep = (size_t)(BK * 2);
    const size_t hstep = (size_t)HALF * K * 2;
    const size_t tstep = 2 * hstep;
    const unsigned ldsw = (unsigned)wid * 1024u;
    const int aoff = lds_byte(wr * 64 + fr, fq * 8), boff = lds_byte(wc * 32 + fr, fq * 8);
#define PG8_SA(b, h) (((b) * 2 + (h)) * HTB)
#define PG8_SB(b, h) ((4 + (b) * 2 + (h)) * HTB)
#define PG8_STAGE(bufoff, gbase, voff) do { _Pragma("unroll") for (int _i = 0; _i < 2; ++_i) \
        __builtin_amdgcn_global_load_lds((const unsigned*)((const char*)(gbase) + (voff)[_i]), (PG8_LAS unsigned*)(lds + (bufoff) + ldsw + _i * 8192), 16, 0, 0); } while (0)
#define PG8_LDA(dst, b, h) do { _Pragma("unroll") for (int m = 0; m < 4; ++m) _Pragma("unroll") for (int k = 0; k < 2; ++k) dst[m][k] = *(const PG8_LAS bf16x8*)(lds + PG8_SA(b, h) + aoff + m * 2048 + k * 1024); } while (0)
#define PG8_LDB(dst, b, h) do { _Pragma("unroll") for (int n = 0; n < 2; ++n) _Pragma("unroll") for (int k = 0; k < 2; ++k) dst[n][k] = *(const PG8_LAS bf16x8*)(lds + PG8_SB(b, h) + boff + n * 2048 + k * 1024); } while (0)
#define PG8_MMA(ai, bj, At, Bt) do { __builtin_amdgcn_s_setprio(1); _Pragma("unroll") for (int m = 0; m < 4; ++m) _Pragma("unroll") for (int n = 0; n < 2; ++n) _Pragma("unroll") for (int k = 0; k < 2; ++k) \
        acc[ai][bj][m][n] = __builtin_amdgcn_mfma_f32_16x16x32_bf16(Bt[n][k], At[m][k], acc[ai][bj][m][n], 0, 0, 0); __builtin_amdgcn_s_setprio(0); } while (0)
#define PG8_WAIT_V(n) asm volatile("s_waitcnt vmcnt(" #n ")" ::: "memory")
#define PG8_WAIT_L(n) asm volatile("s_waitcnt lgkmcnt(" #n ")" ::: "memory")
#define PG8_BAR __builtin_amdgcn_s_barrier()
#define PG8_SCHED __builtin_amdgcn_sched_barrier(0)
    Unit cur, nxt; int ui = 0;
    if (!S.next(0, cur)) return;
    f32x4 acc[2][2][4][2];
#pragma unroll
    for (int a = 0; a < 2; ++a)
#pragma unroll
        for (int b = 0; b < 2; ++b)
#pragma unroll
            for (int m = 0; m < 4; ++m)
#pragma unroll
                for (int n = 0; n < 2; ++n) acc[a][b][m][n] = (f32x4){0.f, 0.f, 0.f, 0.f};
    bf16x8 At[4][2], B0[2][2], B1[2][2];
    const char* cA = (const char*)g.A + (size_t)cur.pm * tstep; const char* cB = (const char*)g.Bt + (size_t)cur.pn * tstep;
    S.a_ready(cur);
    if constexpr (SP2) {
        PG8_STAGE(PG8_SB(0, 0), cB, voffB); PG8_STAGE(PG8_SB(0, 1), cB + hstep, voffB); PG8_STAGE(PG8_SA(0, 0), cA, voffA); PG8_STAGE(PG8_SA(0, 1), cA + hstep, voffA);
        if (wr == 1) PG8_BAR;
        PG8_WAIT_V(2); PG8_BAR;
        PG8_STAGE(PG8_SB(1, 0), cB + kstep, voffB); PG8_STAGE(PG8_SA(1, 0), cA + kstep, voffA); PG8_STAGE(PG8_SB(1, 1), cB + hstep + kstep, voffB);
        PG8_WAIT_V(6); PG8_BAR;
    } else {
        PG8_STAGE(PG8_SB(0, 0), cB, voffB); PG8_STAGE(PG8_SA(0, 0), cA, voffA); PG8_STAGE(PG8_SB(0, 1), cB + hstep, voffB); PG8_STAGE(PG8_SA(0, 1), cA + hstep, voffA);
        if (wr == 1) PG8_BAR;
        PG8_WAIT_V(4); PG8_BAR;
        PG8_STAGE(PG8_SB(1, 0), cB + kstep, voffB); PG8_STAGE(PG8_SA(1, 0), cA + kstep, voffA); PG8_STAGE(PG8_SB(1, 1), cB + hstep + kstep, voffB);
        PG8_WAIT_V(6); PG8_BAR;
    }
    for (;;) {
        const bool has_next = S.next(ui + 1, nxt);
        const char* nA = has_next ? (const char*)g.A + (size_t)nxt.pm * tstep : cA; const char* nB = has_next ? (const char*)g.Bt + (size_t)nxt.pn * tstep : cB;
        for (int t = 0; t < nt; t += 2) {
            const bool last = (t == nt - 2);
            const char* a1 = cA + (size_t)(t + 1) * kstep;
            const char* a2 = last ? nA : cA + (size_t)(t + 2) * kstep; const char* b2 = last ? nB : cB + (size_t)(t + 2) * kstep;
            const char* a3 = a2 + kstep; const char* b3 = b2 + kstep;
            if (last && has_next) S.a_ready(nxt);
            if constexpr (SP2) {
            PG8_LDB(B0, 0, 0); PG8_LDB(B1, 0, 1); PG8_SCHED; PG8_LDA(At, 0, 0); PG8_STAGE(PG8_SA(1, 1), a1 + hstep, voffA);
            PG8_WAIT_V(8); PG8_WAIT_L(0); PG8_BAR; PG8_MMA(0, 0, At, B0); PG8_MMA(0, 1, At, B1); PG8_BAR; PG8_SCHED;
            PG8_LDA(At, 0, 1); PG8_STAGE(PG8_SB(0, 0), b2, voffB); PG8_STAGE(PG8_SB(0, 1), b2 + hstep, voffB); PG8_STAGE(PG8_SA(0, 0), a2, voffA);
            PG8_WAIT_V(8); PG8_WAIT_L(0); PG8_BAR; PG8_MMA(1, 0, At, B0); PG8_MMA(1, 1, At, B1); PG8_BAR; PG8_SCHED;
            PG8_LDB(B0, 1, 0); PG8_LDB(B1, 1, 1); PG8_SCHED; PG8_LDA(At, 1, 0); PG8_STAGE(PG8_SA(0, 1), a2 + hstep, voffA);
            PG8_WAIT_V(8); PG8_WAIT_L(0); PG8_BAR; PG8_MMA(0, 0, At, B0); PG8_MMA(0, 1, At, B1); PG8_BAR; PG8_SCHED;
            PG8_LDA(At, 1, 1); PG8_STAGE(PG8_SB(1, 0), b3, voffB); PG8_STAGE(PG8_SB(1, 1), b3 + hstep, voffB); PG8_STAGE(PG8_SA(1, 0), a3, voffA);
            PG8_WAIT_V(8); PG8_WAIT_L(0); PG8_BAR; PG8_MMA(1, 0, At, B0); PG8_MMA(1, 1, At, B1); PG8_BAR; PG8_SCHED;
            } else {
            PG8_LDB(B0, 0, 0); PG8_SCHED; PG8_LDA(At, 0, 0); PG8_STAGE(PG8_SA(1, 1), a1 + hstep, voffA);
            PG8_WAIT_L(8); PG8_BAR; PG8_WAIT_L(0); PG8_MMA(0, 0, At, B0); PG8_BAR; PG8_SCHED;
            PG8_LDB(B1, 0, 1); PG8_STAGE(PG8_SB(0, 0), b2, voffB);
            PG8_BAR; PG8_WAIT_L(0); PG8_MMA(0, 1, At, B1); PG8_BAR;
            PG8_LDA(At, 0, 1); PG8_STAGE(PG8_SA(0, 0), a2, voffA);
            PG8_BAR; PG8_WAIT_L(0); PG8_MMA(1, 0, At, B0); PG8_BAR; PG8_SCHED;
            PG8_STAGE(PG8_SB(0, 1), b2 + hstep, voffB);
            PG8_WAIT_V(6); PG8_BAR; PG8_MMA(1, 1, At, B1); PG8_BAR;
            PG8_LDB(B0, 1, 0); PG8_SCHED; PG8_LDA(At, 1, 0); PG8_STAGE(PG8_SA(0, 1), a2 + hstep, voffA);
            PG8_WAIT_L(8); PG8_BAR; PG8_WAIT_L(0); PG8_MMA(0, 0, At, B0); PG8_BAR; PG8_SCHED;
            PG8_LDB(B1, 1, 1); PG8_STAGE(PG8_SB(1, 0), b3, voffB);
            PG8_BAR; PG8_WAIT_L(0); PG8_MMA(0, 1, At, B1); PG8_BAR;
            PG8_LDA(At, 1, 1); PG8_STAGE(PG8_SA(1, 0), a3, voffA);
            PG8_BAR; PG8_WAIT_L(0); PG8_MMA(1, 0, At, B0); PG8_BAR; PG8_SCHED;
            PG8_STAGE(PG8_SB(1, 1), b3 + hstep, voffB);
            PG8_WAIT_V(6); PG8_BAR; PG8_MMA(1, 1, At, B1); PG8_BAR;
            }
        }
        if constexpr (ALIGN_EPI) { if (wr == 0) PG8_BAR; }
        if constexpr (!Epi::AFTER_DRAIN) { E(acc, cur, wr, wc, fr, fq); S.done(cur); }
        if (!has_next) break;
#pragma unroll
        for (int a = 0; a < 2; ++a)
#pragma unroll
            for (int b = 0; b < 2; ++b)
#pragma unroll
                for (int m = 0; m < 4; ++m)
#pragma unroll
                    for (int n = 0; n < 2; ++n) acc[a][b][m][n] = (f32x4){0.f, 0.f, 0.f, 0.f};
        cur = nxt; cA = nA; cB = nB; ++ui;
        if constexpr (ALIGN_EPI) { if (wr == 1) PG8_BAR; }
    }
    PG8_WAIT_V(0);
    if constexpr (!ALIGN_EPI) { if (wr == 0) PG8_BAR; }
    PG8_BAR;
    if constexpr (Epi::AFTER_DRAIN) { E.fused(acc, cur, wr, wc, fr, fq, lds, wid, lane); S.done(cur); }
#undef PG8_SA
#undef PG8_SB
#undef PG8_STAGE
#undef PG8_LDA
#undef PG8_LDB
#undef PG8_MMA
#undef PG8_WAIT_V
#undef PG8_WAIT_L
#undef PG8_BAR
#undef PG8_SCHED
}
}

constexpr int NWAVES = 8;
constexpr int DM = 2048, MP = 8192, MS = 1024, MROWS = MP + MS;
constexpr int SEQ = 4096, DSEQ = 64, PAST = 4096, NH = 16, HD = 128;
constexpr int DFF = 5632, NUP = 2 * DFF, PLE = 256, NGRP = 8, GDIM = 256, MLPC = 128;
constexpr float EPS = 1e-6f;
constexpr int N_PHASES = 16;
#ifndef MK_PER_PHASE
#define MK_PER_PHASE 0
#endif

enum { I_XP = 0, I_XS, I_PP, I_PS, I_CK, I_CV, I_SC, I_GMIX, I_WQKV, I_WOSB, I_WIN, I_GV, I_WS, I_BS, I_WOM, I_GFFN, I_WUP, I_CW, I_CB, I_WDN, I_GPLE, I_WPLE, I_WGATE, I_GFIN, N_IN };
constexpr size_t OUT_Y = 0, OUT_KP = (size_t)MROWS * DM, OUT_VP = OUT_KP + (size_t)MP * DM, OUT_KS = OUT_VP + (size_t)MP * DM, OUT_VS = OUT_KS + (size_t)MS * DM,
                 OUT_MLPV = OUT_VS + (size_t)MS * DM, OUT_CP = OUT_MLPV + (size_t)MS * DM, OUT_CS = OUT_CP + (size_t)2 * 2 * 2 * DFF, OUT_END = OUT_CS + (size_t)2 * 16 * 2 * DFF;

constexpr size_t MiB = 1u << 20;
constexpr size_t WS_CTL = 0, WS_SS = 1 * MiB, CTL_ZERO_BYTES = 2 * MiB;
constexpr size_t WS_WQKV = 4 * MiB, WS_WO = 28 * MiB, WS_WIN = 36 * MiB, WS_WOM = 52 * MiB, WS_WUP0 = 60 * MiB, WS_WUP1 = 104 * MiB, WS_WDN0 = 148 * MiB, WS_WDN1 = 170 * MiB,
                 WS_WG0 = 192 * MiB, WS_WG1 = 200 * MiB, WS_WP0 = 208 * MiB, WS_WP1 = 209 * MiB;
constexpr size_t WS_XB0 = 212 * MiB, WS_XB1 = 248 * MiB, WS_H = 284 * MiB, WS_Q = 356 * MiB, WS_O = 392 * MiB, WS_AG = 428 * MiB, WS_ACT = 626 * MiB,
                 WS_E0 = 725 * MiB, WS_E1 = 761 * MiB, WS_PB = 797 * MiB, WS_U = 806 * MiB, WS_V = 842 * MiB, WS_Y = 878 * MiB, WS_END = 914 * MiB;
static_assert(WS_WQKV + (size_t)3 * DM * DM * 2 <= WS_WO && WS_WUP0 + (size_t)NUP * DM * 2 <= WS_WUP1 && WS_WDN0 + (size_t)DM * DFF * 2 <= WS_WDN1 && WS_AG + (size_t)MROWS * NUP * 2 <= WS_ACT &&
              WS_ACT + (size_t)MROWS * DFF * 2 <= WS_E0 && WS_H + (size_t)MROWS * DM * 4 <= WS_Q && WS_PB + (size_t)2 * MROWS * PLE * 2 <= WS_U, "d_ws map");
constexpr int CW_BAR = 4096;
enum { SS_MIX0 = 0, SS_FFN0, SS_PLE0, SS_MIX1, SS_V, SS_FFN1, SS_PLE1, SS_FIN, SS_N };
static_assert((size_t)SS_N * MROWS * 4 <= MiB, "ss arrays inside the memset region");

constexpr int RING_BYTES = 131072;
constexpr int ATT_WAVE_LDS = 64 * 288;
constexpr int GATE_WAVE_LDS = 128 * 96;
constexpr int MISC_OFF = NWAVES * ATT_WAVE_LDS;
constexpr int LDS_BYTES = MISC_OFF + 512;
static_assert(MISC_OFF >= RING_BYTES && NWAVES * GATE_WAVE_LDS <= MISC_OFF && LDS_BYTES <= 160 * 1024, "LDS map");

#define GAS __attribute__((address_space(1)))
#define LAS __attribute__((address_space(3)))
typedef unsigned short bf16;
typedef unsigned v4u __attribute__((ext_vector_type(4)));
typedef unsigned v2u __attribute__((ext_vector_type(2)));
typedef float f32x4 __attribute__((ext_vector_type(4)));
typedef short bf16x8 __attribute__((ext_vector_type(8)));
typedef short s16x4 __attribute__((ext_vector_type(4)));
#define LDS_WAIT() asm volatile("s_waitcnt lgkmcnt(0)" ::: "memory")
#define VM_WAIT() asm volatile("s_waitcnt vmcnt(0)" ::: "memory")
__device__ __forceinline__ unsigned pk2(float lo, float hi) { unsigned r; asm volatile("v_cvt_pk_bf16_f32 %0, %1, %2" : "=v"(r) : "v"(lo), "v"(hi)); return r; }
__device__ __forceinline__ float bf_lo(unsigned w) { return __uint_as_float(w << 16); }
__device__ __forceinline__ float bf_hi(unsigned w) { return __uint_as_float(w & 0xffff0000u); }
__device__ __forceinline__ s16x4 tr_read(const LAS unsigned char* p) { return __builtin_bit_cast(s16x4, __builtin_amdgcn_ds_read_tr16_b64_v4i16((LAS s16x4*)p)); }
__device__ __forceinline__ float wave_sum(float v) {
#pragma unroll
    for (int o = 1; o < 64; o <<= 1) v += __shfl_xor(v, o);
    return v;
}

#define XB_TMO      128
#define XB_XCNT(j)  (256  + 64 * (j))
#define XB_XSUB(j)  (1280 + 64 * (j))
#define XB_XGEN(j)  (2304 + 64 * (j))
#define XB_TOP      3328
#define XB_TOPGEN   3392
#define XCD_BAR_WORDS 3456
#define XB_SPIN_CAP (1u << 18)

__device__ __forceinline__ unsigned xb_ld(unsigned* p)              { return __hip_atomic_load(p, __ATOMIC_RELAXED, __HIP_MEMORY_SCOPE_AGENT); }
__device__ __forceinline__ unsigned xb_add(unsigned* p, unsigned v) { return __hip_atomic_fetch_add(p, v, __ATOMIC_RELAXED, __HIP_MEMORY_SCOPE_AGENT); }
__device__ __forceinline__ unsigned xb_xcc_id() { return (unsigned)__builtin_amdgcn_s_getreg((3 << 11) | 20) & 0xFu; }
#define XB_SPIN(cond, bar) do { unsigned _sp = 0; while (cond) { __builtin_amdgcn_s_sleep(1); \
    if ((++_sp & 255u) == 0u) { if (xb_ld(&(bar)[XB_TMO])) break; if (_sp > XB_SPIN_CAP) { atomicAdd(&(bar)[XB_TMO], 1u); break; } } } } while (0)

struct XcdBarrier {
    unsigned* bar; unsigned x;
    volatile LAS unsigned* st;
};

__device__ __forceinline__ XcdBarrier xcd_barrier_post(unsigned* bar, volatile LAS unsigned* st) {
    XcdBarrier b; b.bar = bar; b.x = xb_xcc_id(); b.st = st;
    if (threadIdx.x == 0) (void)xb_add(&bar[XB_XCNT(b.x)], 1u);
    return b;
}
__device__ __forceinline__ void xcd_barrier_complete(unsigned* bar, unsigned x, unsigned& nloc, unsigned& nx) {
    const unsigned G = gridDim.x * gridDim.y * gridDim.z;
    unsigned sum, cnt, mine, sp = 0u;
    for (;;) {
        sum = 0u; cnt = 0u; mine = 0u;
#pragma unroll
        for (unsigned j = 0; j < 16; ++j) { const unsigned c = xb_ld(&bar[XB_XCNT(j)]); sum += c; cnt += (c > 0u) ? 1u : 0u; mine = (j == x) ? c : mine; }
        if (sum == G) break;
        __builtin_amdgcn_s_sleep(1);
        if ((++sp & 255u) == 0u) { if (xb_ld(&bar[XB_TMO])) break; if (sp > XB_SPIN_CAP) { atomicAdd(&bar[XB_TMO], 1u); break; } }
    }
    nloc = mine > 0u ? mine : 1u; nx = cnt > 0u ? cnt : 1u;
}

__device__ __forceinline__ void xcd_barrier(const XcdBarrier& b) {
    asm volatile("s_waitcnt vmcnt(0)" ::: "memory");
    __syncthreads();
    if (threadIdx.x == 0) {
        unsigned* bar = b.bar;
        __builtin_amdgcn_s_waitcnt(0);
        unsigned nloc = b.st[0], nx = b.st[1];
        if (nloc == 0u) { xcd_barrier_complete(bar, b.x, nloc, nx); b.st[0] = nloc; b.st[1] = nx; }
        const unsigned old = xb_add(&bar[XB_XSUB(b.x)], 1u);
        const unsigned gen = old / nloc;
        if (old + 1u == (gen + 1u) * nloc) {
            __builtin_amdgcn_fence(__ATOMIC_RELEASE, "agent");
            asm volatile("s_waitcnt vmcnt(0)" ::: "memory");
            const unsigned og = xb_add(&bar[XB_TOP], 1u);
            const unsigned tg = og / nx;
            if (og + 1u == (tg + 1u) * nx) xb_add(&bar[XB_TOPGEN], 1u);
            else XB_SPIN(xb_ld(&bar[XB_TOPGEN]) == tg, bar);
            __builtin_amdgcn_fence(__ATOMIC_ACQUIRE, "agent");
            xb_add(&bar[XB_XGEN(b.x)], 1u);
            asm volatile("s_waitcnt vmcnt(0)" ::: "memory");
        } else {
            XB_SPIN(xb_ld(&bar[XB_XGEN(b.x)]) == gen, bar);
            __builtin_amdgcn_fence(__ATOMIC_ACQUIRE, "agent");
            asm volatile("s_waitcnt vmcnt(0)" ::: "memory");
        }
    }
    __syncthreads();
}

__device__ __forceinline__ void p0_transpose_item(const float* W, const float* gain, int K, int N, bf16* WT, LAS float* scr, int item, int lane) {
    const int nblk = N / 32, kb = item / nblk, nb = item % nblk, k0 = 64 * kb, n0 = 32 * nb;
#pragma unroll 8
    for (int i = 0; i < 32; ++i) { const int kk = 2 * i + (lane >> 5); float w = W[(size_t)(k0 + kk) * N + n0 + (lane & 31)]; if (gain) w *= gain[k0 + kk]; scr[kk * 33 + (lane & 31)] = w; }
    LDS_WAIT(); asm volatile("" ::: "memory");
    const int c = lane & 7;
#pragma unroll
    for (int j = 0; j < 4; ++j) { const int n = (lane >> 3) + 8 * j; const LAS float* s = scr + (8 * c) * 33 + n;
        v4u o; o.x = pk2(s[0 * 33], s[1 * 33]); o.y = pk2(s[2 * 33], s[3 * 33]); o.z = pk2(s[4 * 33], s[5 * 33]); o.w = pk2(s[6 * 33], s[7 * 33]);
        *(GAS v4u*)(WT + (size_t)(n0 + n) * K + k0 + 8 * c) = o; }
    LDS_WAIT(); asm volatile("" ::: "memory");
}
struct P0Args { const float* const* in; unsigned char* ws; };
__device__ __forceinline__ void p0_prologue(const float* const (&in)[N_IN], unsigned char* ws, LAS unsigned char* lds, int gw, int NGW, int wave, int lane, int gt, int NGT) {
    LAS float* scr = (LAS float*)(lds + wave * 16384);
    constexpr int I_QKV = (DM / 64) * (3 * DM / 32), I_SQ = (DM / 64) * (DM / 32), I_IN = (DM / 64) * (2 * DM / 32), I_UP = (DM / 64) * (NUP / 32), I_DN = (DFF / 64) * (DM / 32), I_PL = (PLE / 64) * (DM / 32);
    constexpr int NITEMS = I_QKV + I_SQ + I_IN + I_SQ + 2 * I_UP + 2 * I_DN + 2 * I_SQ + 2 * I_PL;
    for (int it = gw; it < NITEMS; it += NGW) {
        int r = it;
        if (r < I_QKV) { p0_transpose_item(in[I_WQKV], in[I_GMIX], DM, 3 * DM, (bf16*)(ws + WS_WQKV), scr, r, lane); continue; } r -= I_QKV;
        if (r < I_SQ) { p0_transpose_item(in[I_WOSB], nullptr, DM, DM, (bf16*)(ws + WS_WO), scr, r, lane); continue; } r -= I_SQ;
        if (r < I_IN) { p0_transpose_item(in[I_WIN], in[I_GMIX] + DM, DM, 2 * DM, (bf16*)(ws + WS_WIN), scr, r, lane); continue; } r -= I_IN;
        if (r < I_SQ) { p0_transpose_item(in[I_WOM], nullptr, DM, DM, (bf16*)(ws + WS_WOM), scr, r, lane); continue; } r -= I_SQ;
        if (r < I_UP) { p0_transpose_item(in[I_WUP], in[I_GFFN], DM, NUP, (bf16*)(ws + WS_WUP0), scr, r, lane); continue; } r -= I_UP;
        if (r < I_UP) { p0_transpose_item(in[I_WUP] + (size_t)DM * NUP, in[I_GFFN] + DM, DM, NUP, (bf16*)(ws + WS_WUP1), scr, r, lane); continue; } r -= I_UP;
        if (r < I_DN) { p0_transpose_item(in[I_WDN], nullptr, DFF, DM, (bf16*)(ws + WS_WDN0), scr, r, lane); continue; } r -= I_DN;
        if (r < I_DN) { p0_transpose_item(in[I_WDN] + (size_t)DFF * DM, nullptr, DFF, DM, (bf16*)(ws + WS_WDN1), scr, r, lane); continue; } r -= I_DN;
        if (r < I_SQ) { p0_transpose_item(in[I_WGATE], in[I_GPLE], DM, DM, (bf16*)(ws + WS_WG0), scr, r, lane); continue; } r -= I_SQ;
        if (r < I_SQ) { p0_transpose_item(in[I_WGATE] + (size_t)DM * DM, in[I_GPLE] + DM, DM, DM, (bf16*)(ws + WS_WG1), scr, r, lane); continue; } r -= I_SQ;
        if (r < I_PL) { p0_transpose_item(in[I_WPLE], nullptr, PLE, DM, (bf16*)(ws + WS_WP0), scr, r, lane); continue; } r -= I_PL;
        p0_transpose_item(in[I_WPLE] + (size_t)PLE * DM, nullptr, PLE, DM, (bf16*)(ws + WS_WP1), scr, r, lane);
    }
    bf16* XB0 = (bf16*)(ws + WS_XB0); float* ss0 = (float*)(ws + WS_SS) + SS_MIX0 * MROWS;
    for (int m = gw; m < MROWS; m += NGW) {
        const float* xrow = m < MP ? in[I_XP] + (size_t)m * DM : in[I_XS] + (size_t)(m - MP) * DM;
        const GAS f32x4* xr = (const GAS f32x4*)xrow + lane; f32x4 v[8]; float s = 0.f;
#pragma unroll
        for (int j = 0; j < 8; ++j) { v[j] = xr[64 * j]; s += (v[j].x * v[j].x + v[j].y * v[j].y) + (v[j].z * v[j].z + v[j].w * v[j].w); }
        s = wave_sum(s); if (lane == 0) ss0[m] = s;
        GAS v2u* o8 = (GAS v2u*)(XB0 + (size_t)m * DM) + lane;
#pragma unroll
        for (int j = 0; j < 8; ++j) { v2u w; w.x = pk2(v[j].x, v[j].y); w.y = pk2(v[j].z, v[j].w); o8[64 * j] = w; }
    }
    bf16* PB = (bf16*)(ws + WS_PB);
    for (int c = gt; c < 2 * MROWS * (PLE / 8); c += NGT) {
        const int i = c / (MROWS * (PLE / 8)), rem = c % (MROWS * (PLE / 8)), row = rem / (PLE / 8), cc = (rem % (PLE / 8)) * 8;
        const float* src = row < MP ? in[I_PP] + ((size_t)i * MP + row) * PLE + cc : in[I_PS] + ((size_t)i * MS + (row - MP)) * PLE + cc;
        const f32x4 a = *(const GAS f32x4*)src, b = *(const GAS f32x4*)(src + 4);
        v4u o; o.x = pk2(a.x, a.y); o.y = pk2(a.z, a.w); o.z = pk2(b.x, b.y); o.w = pk2(b.z, b.w);
        *(GAS v4u*)(PB + ((size_t)i * MROWS + row) * PLE + cc) = o;
    }
}

__device__ __forceinline__ void attn_phase(LAS unsigned char* lds, const bf16* Q, const float* Kp, const float* Vp, const float* Ks, const float* Vs, const float* Kc, const float* Vc, bf16* O,
                                           int gw, int NGW, int wave, int lane) {
    LAS unsigned char* vl = lds + wave * ATT_WAVE_LDS;
    const int g = lane >> 4, i16 = lane & 15;
    const float scale = 0.08838834764831845f;
    const LAS unsigned char* trb = vl + (4 * g + (i16 >> 2)) * 288 + (i16 & 3) * 8;
    LAS unsigned char* stw = vl + (lane >> 5) * 288 + (lane & 31) * 8;
    for (int u = gw; u < (MROWS / 16) * NH; u += NGW) {
        const int head = (u >> 2) & 15, rb = ((u >> 6) << 2) | (u & 3), R0 = rb * 16;
        const bool sample = R0 >= MP;
        int qpos0; const float *knew, *vnew, *kcache = nullptr, *vcache = nullptr;
        if (!sample) { const int b = R0 >> 12; qpos0 = R0 & 4095; knew = Kp + (size_t)b * SEQ * DM + head * HD; vnew = Vp + (size_t)b * SEQ * DM + head * HD; }
        else { const int sb = (R0 - MP) >> 6; qpos0 = PAST + ((R0 - MP) & 63); knew = Ks + (size_t)sb * DSEQ * DM + head * HD; vnew = Vs + (size_t)sb * DSEQ * DM + head * HD;
               kcache = Kc + (size_t)sb * PAST * DM + head * HD; vcache = Vc + (size_t)sb * PAST * DM + head * HD; }
        bf16x8 qf[4];
#pragma unroll
        for (int ds = 0; ds < 4; ++ds) qf[ds] = *(const GAS bf16x8*)(Q + (size_t)(R0 + i16) * DM + head * HD + 32 * ds + 8 * g);
        f32x4 oacc[8];
#pragma unroll
        for (int dt = 0; dt < 8; ++dt) oacc[dt] = (f32x4){0.f, 0.f, 0.f, 0.f};
        float run = 0.f;
        const int qpos = qpos0 + i16;
        for (int kt = (qpos0 + 14) >> 6; kt >= 0; --kt) {
            const float *kp, *vp;
            if (sample && kt < 64) { kp = kcache + (size_t)kt * 64 * DM; vp = vcache + (size_t)kt * 64 * DM; }
            else { const int kl = sample ? 0 : kt; kp = knew + (size_t)kl * 64 * DM; vp = vnew + (size_t)kl * 64 * DM; }
#pragma unroll
            for (int c = 0; c < 4; ++c) { f32x4 v[8];
#pragma unroll
                for (int i = 0; i < 8; ++i) v[i] = *(const GAS f32x4*)(vp + (size_t)(2 * (8 * c + i) + (lane >> 5)) * DM + 4 * (lane & 31));
#pragma unroll
                for (int i = 0; i < 8; ++i) { v2u w; w.x = pk2(v[i].x, v[i].y); w.y = pk2(v[i].z, v[i].w); *(LAS v2u*)(stw + (8 * c + i) * 2 * 288) = w; } }
            f32x4 S[4];
#pragma unroll
            for (int t = 0; t < 4; ++t) { f32x4 a = (f32x4){0.f, 0.f, 0.f, 0.f}; const float* kr = kp + (size_t)(16 * t + i16) * DM + 8 * g; f32x4 k0[4], k1[4];
#pragma unroll
                for (int ds = 0; ds < 4; ++ds) { k0[ds] = *(const GAS f32x4*)(kr + 32 * ds); k1[ds] = *(const GAS f32x4*)(kr + 32 * ds + 4); }
#pragma unroll
                for (int ds = 0; ds < 4; ++ds) { v4u kk; kk.x = pk2(k0[ds].x, k0[ds].y); kk.y = pk2(k0[ds].z, k0[ds].w); kk.z = pk2(k1[ds].x, k1[ds].y); kk.w = pk2(k1[ds].z, k1[ds].w);
                    a = __builtin_amdgcn_mfma_f32_16x16x32_bf16(__builtin_bit_cast(bf16x8, kk), qf[ds], a, 0, 0, 0); }
                S[t] = a; }
            float lk[4][4], lb[4][4];
            const int kbase = kt * 64 + 4 * g;
#pragma unroll
            for (int t = 0; t < 4; ++t)
#pragma unroll
                for (int r = 0; r < 4; ++r) { const float z = S[t][r] * scale; const bool valid = (kbase + 16 * t + r) < qpos;
                    const float e = __builtin_amdgcn_exp2f(-1.4426950408889634f * __builtin_fabsf(z));
                    const float sp = __builtin_fmaxf(z, 0.f) + 0.6931471805599453f * __builtin_amdgcn_logf(1.0f + e);
                    lk[t][r] = valid ? -sp : 0.f; lb[t][r] = valid ? (z - sp) : -INFINITY; }
            float T[4], above[4];
#pragma unroll
            for (int t = 0; t < 4; ++t) { const float a = (lk[t][0] + lk[t][1]) + (lk[t][2] + lk[t][3]); const float b = __shfl_xor(a, 16); const float c = a + b; const float d = __shfl_xor(c, 32);
                T[t] = c + d; above[t] = ((g & 1) ? 0.f : b) + ((g & 2) ? 0.f : d); }
            float w[4][4];
            float st = run;
#pragma unroll
            for (int t = 3; t >= 0; --t) { float la = st + above[t];
#pragma unroll
                for (int r = 3; r >= 0; --r) { w[t][r] = __builtin_amdgcn_exp2f(1.4426950408889634f * (lb[t][r] + la)); la += lk[t][r]; }
                st += T[t]; }
            run = st;
            asm volatile("s_waitcnt lgkmcnt(0)" ::: "memory");
#pragma unroll
            for (int ks = 0; ks < 2; ++ks) { v4u pw; pw.x = pk2(w[2 * ks][0], w[2 * ks][1]); pw.y = pk2(w[2 * ks][2], w[2 * ks][3]); pw.z = pk2(w[2 * ks + 1][0], w[2 * ks + 1][1]); pw.w = pk2(w[2 * ks + 1][2], w[2 * ks + 1][3]);
                const bf16x8 pf = __builtin_bit_cast(bf16x8, pw);
#pragma unroll
                for (int dt = 0; dt < 8; ++dt) { const s16x4 lo = tr_read(trb + (2 * ks) * 16 * 288 + dt * 32), hi = tr_read(trb + (2 * ks + 1) * 16 * 288 + dt * 32);
                    const bf16x8 vf = (bf16x8){lo[0], lo[1], lo[2], lo[3], hi[0], hi[1], hi[2], hi[3]};
                    oacc[dt] = __builtin_amdgcn_mfma_f32_16x16x32_bf16(vf, pf, oacc[dt], 0, 0, 0); } }
            asm volatile("s_waitcnt lgkmcnt(0)" ::: "memory");
            if (__all(run < -104.0f)) break;
        }
        bf16* orow = O + (size_t)(R0 + i16) * DM + head * HD + 4 * g;
#pragma unroll
        for (int dt = 0; dt < 8; ++dt) { v2u o; o.x = pk2(oacc[dt][0], oacc[dt][1]); o.y = pk2(oacc[dt][2], oacc[dt][3]); *(GAS v2u*)(orow + 16 * dt) = o; }
    }
}

__device__ __forceinline__ void conv_phase(const bf16* AG, bf16* ACT, const float* cw, const float* cb, const float* state  , float* outp  ,
                                           float* outs  , int gt, int NGT) {
    constexpr int CC = DFF / 8, SEG = 32, NSEG = MROWS / SEG;
    for (int u = gt; u < NSEG * CC; u += NGT) {
        const int seg = u / CC, col = (u % CC) * 8, row0 = seg * SEG;
        float w0[8], w1[8], w2[8], bb[8];
#pragma unroll
        for (int j = 0; j < 8; j += 4) { const f32x4 a = *(const GAS f32x4*)(cw + col + j), b = *(const GAS f32x4*)(cw + DFF + col + j), c = *(const GAS f32x4*)(cw + 2 * DFF + col + j), d = *(const GAS f32x4*)(cb + col + j);
#pragma unroll
            for (int q = 0; q < 4; ++q) { w0[j + q] = a[q]; w1[j + q] = b[q]; w2[j + q] = c[q]; bb[j + q] = d[q]; } }
        const bool prompt = row0 < MP; const int tloc = prompt ? (row0 & (SEQ - 1)) : ((row0 - MP) & (DSEQ - 1)); const int sb = prompt ? (row0 >> 12) : ((row0 - MP) >> 6);
        float p2[8], p1[8];
        if (tloc == 0) {
            if (prompt) {
#pragma unroll
                for (int j = 0; j < 8; ++j) { p2[j] = 0.f; p1[j] = 0.f; }
            } else {
#pragma unroll
                for (int j = 0; j < 8; j += 4) { const f32x4 a = *(const GAS f32x4*)(state + ((size_t)sb * 2 + 0) * DFF + col + j), b = *(const GAS f32x4*)(state + ((size_t)sb * 2 + 1) * DFF + col + j);
#pragma unroll
                    for (int q = 0; q < 4; ++q) { p2[j + q] = a[q]; p1[j + q] = b[q]; } }
            }
        } else {
            const v4u a = *(const GAS v4u*)(AG + (size_t)(row0 - 2) * NUP + col), b = *(const GAS v4u*)(AG + (size_t)(row0 - 1) * NUP + col);
            p2[0] = bf_lo(a.x); p2[1] = bf_hi(a.x); p2[2] = bf_lo(a.y); p2[3] = bf_hi(a.y); p2[4] = bf_lo(a.z); p2[5] = bf_hi(a.z); p2[6] = bf_lo(a.w); p2[7] = bf_hi(a.w);
            p1[0] = bf_lo(b.x); p1[1] = bf_hi(b.x); p1[2] = bf_lo(b.y); p1[3] = bf_hi(b.y); p1[4] = bf_lo(b.z); p1[5] = bf_hi(b.z); p1[6] = bf_lo(b.w); p1[7] = bf_hi(b.w);
        }
#pragma unroll 4
        for (int r = 0; r < SEG; ++r) {
            const v4u av = *(const GAS v4u*)(AG + (size_t)(row0 + r) * NUP + col), gv = *(const GAS v4u*)(AG + (size_t)(row0 + r) * NUP + DFF + col);
            float a[8], gg[8], o[8];
            a[0] = bf_lo(av.x); a[1] = bf_hi(av.x); a[2] = bf_lo(av.y); a[3] = bf_hi(av.y); a[4] = bf_lo(av.z); a[5] = bf_hi(av.z); a[6] = bf_lo(av.w); a[7] = bf_hi(av.w);
            gg[0] = bf_lo(gv.x); gg[1] = bf_hi(gv.x); gg[2] = bf_lo(gv.y); gg[3] = bf_hi(gv.y); gg[4] = bf_lo(gv.z); gg[5] = bf_hi(gv.z); gg[6] = bf_lo(gv.w); gg[7] = bf_hi(gv.w);
#pragma unroll
            for (int j = 0; j < 8; ++j) { const float ac = bb[j] + p2[j] * w0[j] + p1[j] * w1[j] + a[j] * w2[j]; o[j] = pg8::gelu_tanh(ac) * gg[j]; p2[j] = p1[j]; p1[j] = a[j]; }
            v4u ov; ov.x = pk2(o[0], o[1]); ov.y = pk2(o[2], o[3]); ov.z = pk2(o[4], o[5]); ov.w = pk2(o[6], o[7]);
            *(GAS v4u*)(ACT + (size_t)(row0 + r) * DFF + col) = ov;
        }
        const int tend = tloc + SEG;
        if (tend == (prompt ? SEQ : DSEQ)) {
            float* dst = prompt ? outp + (size_t)sb * 2 * DFF + col : outs + (size_t)sb * 2 * DFF + col;
            *(GAS f32x4*)(dst) = (f32x4){p2[0], p2[1], p2[2], p2[3]}; *(GAS f32x4*)(dst + 4) = (f32x4){p2[4], p2[5], p2[6], p2[7]};
            *(GAS f32x4*)(dst + DFF) = (f32x4){p1[0], p1[1], p1[2], p1[3]}; *(GAS f32x4*)(dst + DFF + 4) = (f32x4){p1[4], p1[5], p1[6], p1[7]};
        }
    }
}

__device__ __forceinline__ void gate_phase(LAS unsigned char* lds, const bf16* U, const bf16* V, const float* ssv, const float* gv, const float* Ws, const float* bs, bf16* Y, float* mlpv,
                                           int gw, int NGW, int wave, int lane) {
    LAS unsigned char* gl = lds + wave * GATE_WAVE_LDS;
    const int g = lane >> 4, i16 = lane & 15;
    const LAS unsigned char* trb = gl + (4 * g + (i16 >> 2)) * 96 + (i16 & 3) * 8;
    constexpr int NU_P = (MP / MLPC) * NGRP * 8, NU_S = (MS / DSEQ) * NGRP * 8;
    for (int u = gw; u < NU_P + NU_S; u += NGW) {
        const bool sample = u >= NU_P; const int uu = sample ? u - NU_P : u;
        const int ch = uu >> 6, gr = (uu >> 3) & 7, dsl = uu & 7;
        const int row0 = sample ? MP + ch * DSEQ : ch * MLPC, L = sample ? DSEQ : MLPC, col0 = gr * GDIM + dsl * 32;
        const int cc = 4 * (lane & 7);
        const f32x4 gvv = *(const GAS f32x4*)(gv + col0 + cc);
        for (int i = 0; i < L / 8; ++i) { const int row = 8 * i + (lane >> 3); const v2u vv = *(const GAS v2u*)(V + (size_t)(row0 + row) * DM + col0 + cc); const float rs = pg8::rstd_of(ssv[row0 + row]);
            f32x4 vn; vn[0] = bf_lo(vv.x) * rs * gvv[0]; vn[1] = bf_hi(vv.x) * rs * gvv[1]; vn[2] = bf_lo(vv.y) * rs * gvv[2]; vn[3] = bf_hi(vv.y) * rs * gvv[3];
            if (sample) *(GAS f32x4*)(mlpv + (size_t)(row0 - MP + row) * DM + col0 + cc) = vn;
            v2u w; w.x = pk2(vn[0], vn[1]); w.y = pk2(vn[2], vn[3]); *(LAS v2u*)(gl + row * 96 + (lane & 7) * 8) = w; }
        asm volatile("s_waitcnt lgkmcnt(0)" ::: "memory");
        bf16x8 af[4][2];
#pragma unroll
        for (int ks = 0; ks < 4; ++ks)
#pragma unroll
            for (int dd = 0; dd < 2; ++dd) { if (ks < 2 || !sample) { const s16x4 lo = tr_read(trb + ks * 32 * 96 + dd * 32), hi = tr_read(trb + ks * 32 * 96 + 16 * 96 + dd * 32);
                af[ks][dd] = (bf16x8){lo[0], lo[1], lo[2], lo[3], hi[0], hi[1], hi[2], hi[3]}; } else af[ks][dd] = (bf16x8){0, 0, 0, 0, 0, 0, 0, 0}; }
        asm volatile("s_waitcnt lgkmcnt(0)" ::: "memory");
        for (int tt = 0; tt < L / 16; ++tt) {
            const int t = 16 * tt + i16; const int nks = (!sample && tt >= 4) ? 4 : 2;
            f32x4 acc0 = (f32x4){0.f, 0.f, 0.f, 0.f}, acc1 = acc0;
            const float* wrow = Ws + ((size_t)gr * MLPC + t) * MLPC + 4 * g;
#pragma unroll
            for (int ks = 0; ks < 4; ++ks) if (ks < nks) { const f32x4 wa = *(const GAS f32x4*)(wrow + 32 * ks), wb = *(const GAS f32x4*)(wrow + 32 * ks + 16);
                v4u pw; pw.x = pk2(wa[0], wa[1]); pw.y = pk2(wa[2], wa[3]); pw.z = pk2(wb[0], wb[1]); pw.w = pk2(wb[2], wb[3]); const bf16x8 bf = __builtin_bit_cast(bf16x8, pw);
                acc0 = __builtin_amdgcn_mfma_f32_16x16x32_bf16(af[ks][0], bf, acc0, 0, 0, 0); acc1 = __builtin_amdgcn_mfma_f32_16x16x32_bf16(af[ks][1], bf, acc1, 0, 0, 0); }
            const float bias = bs[gr * MLPC + t];
            const size_t o = (size_t)(row0 + t) * DM + col0 + 4 * g;
            const v2u u0 = *(const GAS v2u*)(U + o), u1 = *(const GAS v2u*)(U + o + 16);
            v2u y0, y1; y0.x = pk2(bf_lo(u0.x) * (acc0[0] + bias), bf_hi(u0.x) * (acc0[1] + bias)); y0.y = pk2(bf_lo(u0.y) * (acc0[2] + bias), bf_hi(u0.y) * (acc0[3] + bias));
            y1.x = pk2(bf_lo(u1.x) * (acc1[0] + bias), bf_hi(u1.x) * (acc1[1] + bias)); y1.y = pk2(bf_lo(u1.y) * (acc1[2] + bias), bf_hi(u1.y) * (acc1[3] + bias));
            *(GAS v2u*)(Y + o) = y0; *(GAS v2u*)(Y + o + 16) = y1;
        }
        asm volatile("s_waitcnt lgkmcnt(0)" ::: "memory");
    }
}

__device__ __forceinline__ void final_phase(const float* H, const float* ss, const float* gf, float* out, int gw, int NGW, int lane) {
    f32x4 gq[8];
#pragma unroll
    for (int j = 0; j < 8; ++j) gq[j] = *((const GAS f32x4*)gf + lane + 64 * j);
    for (int m = gw; m < MROWS; m += NGW) { const float rs = pg8::rstd_of(ss[m]); const GAS f32x4* hr = (const GAS f32x4*)(H + (size_t)m * DM) + lane; GAS f32x4* orow = (GAS f32x4*)(out + (size_t)m * DM) + lane;
#pragma unroll
        for (int j = 0; j < 8; ++j) { const f32x4 v = hr[64 * j]; orow[64 * j] = v * rs * gq[j]; } }
}

struct Args { const float* in[N_IN]; float* out; unsigned char* ws; int ph_lo, ph_hi; };
static_assert(sizeof(Args) == (N_IN + 2) * 8 + 8, "Args has no holes");

__global__ void __launch_bounds__(NWAVES * 64, 2) mk_fwd(Args args) {
    extern __shared__ __attribute__((aligned(16))) unsigned char lds_raw[];
    LAS unsigned char* lds = (LAS unsigned char*)lds_raw;
    const int tid = threadIdx.x, lane = tid & 63, wave = __builtin_amdgcn_readfirstlane(tid >> 6);
    const int G = gridDim.x, bx = blockIdx.x, vcu = (G % 8 == 0) ? (bx % 8) * (G / 8) + bx / 8 : bx;
    const int gw = vcu * NWAVES + wave, NGW = G * NWAVES, gt = vcu * (NWAVES * 64) + tid, NGT = G * NWAVES * 64;
    unsigned char* ws = args.ws; float* out = args.out;
    volatile LAS unsigned* MISC = (volatile LAS unsigned*)(lds + MISC_OFF);
    for (int u = tid; u < (LDS_BYTES - MISC_OFF) / 4; u += NWAVES * 64) MISC[u] = 0u;
    __syncthreads();
    const int lo = args.ph_lo, hi = args.ph_hi;
    XcdBarrier bar; bar.bar = (unsigned*)(ws + WS_CTL) + CW_BAR; bar.x = 0; bar.st = nullptr;
    if (hi - lo > 1) bar = xcd_barrier_post((unsigned*)(ws + WS_CTL) + CW_BAR, MISC + 8);
#define IN(k) (lo <= (k) && (k) < hi)
#define SEAM(k) do { if (IN(k) && IN((k) + 1)) xcd_barrier(bar); } while (0)

    float* ssb = (float*)(ws + WS_SS);
    bf16* XB0 = (bf16*)(ws + WS_XB0); bf16* XB1 = (bf16*)(ws + WS_XB1); float* H = (float*)(ws + WS_H);
    bf16* Qb = (bf16*)(ws + WS_Q); bf16* Ob = (bf16*)(ws + WS_O); bf16* AG = (bf16*)(ws + WS_AG); bf16* ACT = (bf16*)(ws + WS_ACT);
    bf16* E0 = (bf16*)(ws + WS_E0); bf16* E1 = (bf16*)(ws + WS_E1); bf16* PB = (bf16*)(ws + WS_PB); bf16* Ub = (bf16*)(ws + WS_U); bf16* Vb = (bf16*)(ws + WS_V); bf16* Yb = (bf16*)(ws + WS_Y);

    if (IN(0)) { p0_prologue(args.in, ws, lds, gw, NGW, wave, lane, gt, NGT); __syncthreads(); }
    SEAM(0);
    if (IN(1)) {
        { pg8::Gemm g{XB0, (const bf16*)(ws + WS_WQKV), MROWS, 3 * DM, DM}; pg8::StaticOrder S; S.init(MROWS, 3 * DM, G, bx);
          pg8::EpiQKV E{Qb, out, ssb + SS_MIX0 * MROWS};
          pg8::gemm_phase<pg8::EpiQKV, pg8::StaticOrder, true, true>(lds, g, S, E); }
        { pg8::Gemm g{PB, (const bf16*)(ws + WS_WP0), MROWS, DM, PLE}; pg8::StaticOrder S; S.init(MROWS, DM, G, bx);
          pg8::EpiScaleBf16 E{E0, DM, nullptr};
          pg8::gemm_phase<pg8::EpiScaleBf16, pg8::StaticOrder, true, true>(lds, g, S, E); }
        { pg8::Gemm g{PB + (size_t)MROWS * PLE, (const bf16*)(ws + WS_WP1), MROWS, DM, PLE}; pg8::StaticOrder S; S.init(MROWS, DM, G, bx);
          pg8::EpiScaleBf16 E{E1, DM, nullptr};
          pg8::gemm_phase<pg8::EpiScaleBf16, pg8::StaticOrder, true, true>(lds, g, S, E); }
    }
    SEAM(1);
    if (IN(2)) { attn_phase(lds, Qb, out + OUT_KP, out + OUT_VP, out + OUT_KS, out + OUT_VS, args.in[I_CK], args.in[I_CV], Ob, gw, NGW, wave, lane); __syncthreads(); }
    SEAM(2);
    if (IN(3)) { pg8::Gemm g{Ob, (const bf16*)(ws + WS_WO), MROWS, DM, DM}; pg8::StaticOrder S; S.init(MROWS, DM, G, bx);
        pg8::EpiRes E{args.in[I_XP], args.in[I_XS], H, XB1, ssb + SS_FFN0 * MROWS};
        pg8::gemm_phase<pg8::EpiRes, pg8::StaticOrder, true, true>(lds, g, S, E); }
    SEAM(3);
    if (IN(4)) { pg8::Gemm g{XB1, (const bf16*)(ws + WS_WUP0), MROWS, NUP, DM}; pg8::StaticOrder S; S.init(MROWS, NUP, G, bx);
        pg8::EpiScaleBf16 E{AG, NUP, ssb + SS_FFN0 * MROWS};
        pg8::gemm_phase<pg8::EpiScaleBf16, pg8::StaticOrder, true, true>(lds, g, S, E); }
    SEAM(4);
    if (IN(5)) conv_phase(AG, ACT, args.in[I_CW], args.in[I_CB], args.in[I_SC], out + OUT_CP, out + OUT_CS, gt, NGT);
    SEAM(5);
    if (IN(6)) { pg8::Gemm g{ACT, (const bf16*)(ws + WS_WDN0), MROWS, DM, DFF}; pg8::StaticOrder S; S.init(MROWS, DM, G, bx);
        pg8::EpiRes E{H, H + (size_t)MP * DM, H, XB0, ssb + SS_PLE0 * MROWS};
        pg8::gemm_phase<pg8::EpiRes, pg8::StaticOrder, true, true>(lds, g, S, E); }
    SEAM(6);
    if (IN(7)) { pg8::Gemm g{XB0, (const bf16*)(ws + WS_WG0), MROWS, DM, DM}; pg8::StaticOrder S; S.init(MROWS, DM, G, bx);
        pg8::EpiGate E{H, E0, XB1, ssb + SS_PLE0 * MROWS, ssb + SS_MIX1 * MROWS};
        pg8::gemm_phase<pg8::EpiGate, pg8::StaticOrder, true, true>(lds, g, S, E); }
    SEAM(7);
    if (IN(8)) { pg8::Gemm g{XB1, (const bf16*)(ws + WS_WIN), MROWS, 2 * DM, DM}; pg8::StaticOrder S; S.init(MROWS, 2 * DM, G, bx);
        pg8::EpiIn E{Ub, Vb, ssb + SS_MIX1 * MROWS, ssb + SS_V * MROWS};
        pg8::gemm_phase<pg8::EpiIn, pg8::StaticOrder, true, true>(lds, g, S, E); }
    SEAM(8);
    if (IN(9)) { gate_phase(lds, Ub, Vb, ssb + SS_V * MROWS, args.in[I_GV], args.in[I_WS], args.in[I_BS], Yb, out + OUT_MLPV, gw, NGW, wave, lane); __syncthreads(); }
    SEAM(9);
    if (IN(10)) { pg8::Gemm g{Yb, (const bf16*)(ws + WS_WOM), MROWS, DM, DM}; pg8::StaticOrder S; S.init(MROWS, DM, G, bx);
        pg8::EpiRes E{H, H + (size_t)MP * DM, H, XB0, ssb + SS_FFN1 * MROWS};
        pg8::gemm_phase<pg8::EpiRes, pg8::StaticOrder, true, true>(lds, g, S, E); }
    SEAM(10);
    if (IN(11)) { pg8::Gemm g{XB0, (const bf16*)(ws + WS_WUP1), MROWS, NUP, DM}; pg8::StaticOrder S; S.init(MROWS, NUP, G, bx);
        pg8::EpiScaleBf16 E{AG, NUP, ssb + SS_FFN1 * MROWS};
        pg8::gemm_phase<pg8::EpiScaleBf16, pg8::StaticOrder, true, true>(lds, g, S, E); }
    SEAM(11);
    if (IN(12)) conv_phase(AG, ACT, args.in[I_CW] + 3 * DFF, args.in[I_CB] + DFF, args.in[I_SC] + (size_t)16 * 2 * DFF, out + OUT_CP + (size_t)2 * 2 * DFF, out + OUT_CS + (size_t)16 * 2 * DFF, gt, NGT);
    SEAM(12);
    if (IN(13)) { pg8::Gemm g{ACT, (const bf16*)(ws + WS_WDN1), MROWS, DM, DFF}; pg8::StaticOrder S; S.init(MROWS, DM, G, bx);
        pg8::EpiRes E{H, H + (size_t)MP * DM, H, XB1, ssb + SS_PLE1 * MROWS};
        pg8::gemm_phase<pg8::EpiRes, pg8::StaticOrder, true, true>(lds, g, S, E); }
    SEAM(13);
    if (IN(14)) { pg8::Gemm g{XB1, (const bf16*)(ws + WS_WG1), MROWS, DM, DM}; pg8::StaticOrder S; S.init(MROWS, DM, G, bx);
        pg8::EpiGate E{H, E1, XB0, ssb + SS_PLE1 * MROWS, ssb + SS_FIN * MROWS};
        pg8::gemm_phase<pg8::EpiGate, pg8::StaticOrder, true, true>(lds, g, S, E); }
    SEAM(14);
    if (IN(15)) final_phase(H, ssb + SS_FIN * MROWS, args.in[I_GFIN], out + OUT_Y, gw, NGW, lane);
#undef IN
#undef SEAM
}

extern "C" void kernel_launch(void* const* d_in, const int* in_sizes, int n_in, void* d_out, int out_size, void* d_ws, size_t ws_size, hipStream_t stream) {
    static int grid = 0;
    if (grid == 0) {
        if (n_in != N_IN || (size_t)out_size != OUT_END || ws_size < WS_END) { fprintf(stderr, "kernel_launch: unexpected problem shape (n_in %d, out %d, ws %zu); nothing launched\n", n_in, out_size, ws_size); grid = -1; return; }
        int dev = 0, cus = 0, per_cu = 0;
        if (hipGetDevice(&dev) != hipSuccess || hipDeviceGetAttribute(&cus, hipDeviceAttributeMultiprocessorCount, dev) != hipSuccess) { fprintf(stderr, "kernel_launch: device query failed\n"); grid = -1; return; }
        if (hipFuncSetAttribute((const void*)mk_fwd, hipFuncAttributeMaxDynamicSharedMemorySize, LDS_BYTES) != hipSuccess) { fprintf(stderr, "kernel_launch: hipFuncSetAttribute failed\n"); grid = -1; return; }
        if (hipOccupancyMaxActiveBlocksPerMultiprocessor(&per_cu, (const void*)mk_fwd, NWAVES * 64, LDS_BYTES) != hipSuccess || per_cu < 1) { fprintf(stderr, "kernel_launch: occupancy query reports %d workgroups per CU\n", per_cu); }
        (void)hipGetLastError();
        grid = cus;
    }
    if (grid < 0) return;
    if (hipMemsetAsync((char*)d_ws + WS_CTL, 0, CTL_ZERO_BYTES, stream) != hipSuccess) { fprintf(stderr, "kernel_launch: memset failed\n"); return; }
    Args a{};
    for (int i = 0; i < N_IN; ++i) a.in[i] = (const float*)d_in[i];
    a.out = (float*)d_out; a.ws = (unsigned char*)d_ws;
#if MK_PER_PHASE
    for (int p = 0; p < N_PHASES; ++p) { a.ph_lo = p; a.ph_hi = p + 1; hipLaunchKernelGGL(mk_fwd, dim3(grid), dim3(NWAVES * 64), LDS_BYTES, stream, a); }
#else
    a.ph_lo = 0; a.ph_hi = N_PHASES;
    hipLaunchKernelGGL(mk_fwd, dim3(grid), dim3(NWAVES * 64), LDS_BYTES, stream, a);
#endif
    const hipError_t le = hipPeekAtLastError();
    if (le != hipSuccess) fprintf(stderr, "kernel_launch: launch failed: %s\n", hipGetErrorName(le));
}
```
